# Optimizing an MI355X kernel written in HIP

```python
import math
import jax
import jax.numpy as jnp
from jax import lax

D_MODEL = 1024
BATCH = 2
SEQ = 8192
DEPTH = 1

D_MIX = D_MODEL
HEAD_DIM = 64
N_Q_HEADS = 8
N_KV_HEADS = 2
Q_PER_KV = N_Q_HEADS // N_KV_HEADS
ATTN_WIDTH = N_Q_HEADS * HEAD_DIM
KV_WIDTH = N_KV_HEADS * HEAD_DIM
WINDOW = 128
ATTN_BLOCK = 128
ROPE_THETA = 10000.0
S5_WIDTH = D_MIX - ATTN_WIDTH
S5_GROUP_CH = 16
S5_GROUPS = S5_WIDTH // S5_GROUP_CH
S5_STATE = 64
IN_WIDTH = ATTN_WIDTH + 2 * KV_WIDTH + S5_WIDTH
N_MEM = 256
X_HEADS = 4
X_HEAD_DIM = D_MODEL // X_HEADS
N_EXPERTS = 32
TOP_K = 4
D_EXPERT = D_MODEL
SWIGLU_LIMIT = 7.0
SWIGLU_ALPHA = 1.702
MOE_BLOCK = 512
LN_EPS = 1e-5
DEEPNORM_ALPHA = (2.0 * DEPTH) ** 0.25
DEEPNORM_BETA = (8.0 * DEPTH) ** -0.25

kernel_name = 'hybrid_swa_s5_moe_deepnorm'

F32 = jnp.float32


def layer_norm(x, g, b):
    xf = x.astype(F32)
    mu = jnp.mean(xf, -1, keepdims=True)
    var = jnp.mean(jnp.square(xf - mu), -1, keepdims=True)
    return ((xf - mu) * lax.rsqrt(var + LN_EPS) * g.astype(F32) + b.astype(F32)).astype(x.dtype)


def rope_tables(seq_len):
    half = HEAD_DIM // 2
    inv_freq = ROPE_THETA ** (-jnp.arange(half, dtype=F32) * (2.0 / HEAD_DIM))
    ang = jnp.arange(seq_len, dtype=F32)[:, None] * inv_freq[None, :]
    return jnp.cos(ang), jnp.sin(ang)


def apply_rope(x, cos, sin):
    half = HEAD_DIM // 2
    xf = x.astype(F32)
    x1, x2 = xf[..., :half], xf[..., half:]
    c = cos[None, :, None, :]
    s = sin[None, :, None, :]
    return jnp.concatenate([x1 * c - x2 * s, x2 * c + x1 * s], -1).astype(x.dtype)


def sliding_window_attention(q, k, v, sinks):
    B, L = q.shape[:2]
    nb = L // ATTN_BLOCK
    qb = q.reshape(B, nb, ATTN_BLOCK, N_KV_HEADS, Q_PER_KV, HEAD_DIM)

    def band(t):
        pad = jnp.zeros((B, ATTN_BLOCK, N_KV_HEADS, HEAD_DIM), t.dtype)
        tb = jnp.concatenate([pad, t], 1).reshape(B, nb + 1, ATTN_BLOCK, N_KV_HEADS, HEAD_DIM)
        return jnp.concatenate([tb[:, :-1], tb[:, 1:]], 2)

    kb, vb = band(k), band(v)
    s = jnp.einsum('bnqkgd,bnskd->bnkgqs', qb, kb).astype(F32) * (HEAD_DIM ** -0.5)
    qi = jnp.arange(ATTN_BLOCK)[:, None]
    si = jnp.arange(2 * ATTN_BLOCK)[None, :]
    rel = qi + ATTN_BLOCK - si
    in_window = (rel >= 0) & (rel < WINDOW)
    key_pos = (jnp.arange(nb) - 1)[:, None] * ATTN_BLOCK + si
    valid = in_window[None] & (key_pos >= 0)[:, None, :]
    s = jnp.where(valid[None, :, None, None], s, -jnp.inf)
    sink = sinks.astype(F32).reshape(N_KV_HEADS, Q_PER_KV)[None, None, :, :, None, None]
    sink = jnp.broadcast_to(sink, s.shape[:-1] + (1,))
    p = jax.nn.softmax(jnp.concatenate([s, sink], -1), axis=-1)[..., :-1]
    o = jnp.einsum('bnkgqs,bnskd->bnqkgd', p.astype(v.dtype), vb)
    return o.reshape(B, L, ATTN_WIDTH)


def s5_mixer(u, lam_re, lam_im, log_dt, b_re, b_im, c_re, c_im, d_skip, w_glu, b_glu):
    B, L, _ = u.shape
    ug = u.reshape(B, L, S5_GROUPS, S5_GROUP_CH).astype(F32)
    lr = jnp.minimum(lam_re.astype(F32), -1e-4)
    li = lam_im.astype(F32)
    dt = jnp.exp(log_dt.astype(F32))[:, None]
    mag = jnp.exp(lr * dt)
    ar = mag * jnp.cos(li * dt)
    ai = mag * jnp.sin(li * dt)
    den = lr * lr + li * li
    zr = ((ar - 1.0) * lr + ai * li) / den
    zi = (ai * lr - (ar - 1.0) * li) / den
    br = b_re.astype(F32)
    bi = b_im.astype(F32)
    bbr = zr[..., None] * br - zi[..., None] * bi
    bbi = zr[..., None] * bi + zi[..., None] * br
    bu_r = jnp.einsum('blgh,gph->blgp', ug, bbr)
    bu_i = jnp.einsum('blgh,gph->blgp', ug, bbi)
    a_r = jnp.broadcast_to(ar, bu_r.shape)
    a_i = jnp.broadcast_to(ai, bu_i.shape)

    def combine(e1, e2):
        a1r, a1i, s1r, s1i = e1
        a2r, a2i, s2r, s2i = e2
        return (a2r * a1r - a2i * a1i,
                a2r * a1i + a2i * a1r,
                a2r * s1r - a2i * s1i + s2r,
                a2r * s1i + a2i * s1r + s2i)

    _, _, st_r, st_i = lax.associative_scan(combine, (a_r, a_i, bu_r, bu_i), axis=1)
    y = (jnp.einsum('blgp,ghp->blgh', st_r, c_re.astype(F32))
         - jnp.einsum('blgp,ghp->blgh', st_i, c_im.astype(F32)))
    y = y.reshape(B, L, S5_WIDTH) + d_skip.astype(F32) * u.astype(F32)
    y = jax.nn.gelu(y).astype(u.dtype)
    return y * jax.nn.sigmoid(y @ w_glu + b_glu)


def memory_cross_attention(x, mem, w_q, w_kv, w_o):
    B, L, _ = x.shape
    q = (x @ w_q).reshape(B, L, X_HEADS, X_HEAD_DIM)
    k, v = jnp.split(mem @ w_kv, 2, axis=-1)
    k = k.reshape(B, N_MEM, X_HEADS, X_HEAD_DIM)
    v = v.reshape(B, N_MEM, X_HEADS, X_HEAD_DIM)
    s = jnp.einsum('blhd,bmhd->bhlm', q, k).astype(F32) * (X_HEAD_DIM ** -0.5)
    p = jax.nn.softmax(s, axis=-1).astype(v.dtype)
    o = jnp.einsum('bhlm,bmhd->blhd', p, v).reshape(B, L, D_MODEL)
    return o @ w_o


def clamped_swiglu(h):
    g = jnp.minimum(h[..., ::2], SWIGLU_LIMIT)
    lin = jnp.clip(h[..., 1::2], -SWIGLU_LIMIT, SWIGLU_LIMIT)
    return g * jax.nn.sigmoid(SWIGLU_ALPHA * g) * (lin + 1.0)


def moe_ffn(x2d, w_router, b_router, w1, b1, w2, b2):
    N, D = x2d.shape
    logits = (x2d @ w_router + b_router).astype(F32)
    top_val, top_idx = lax.top_k(logits, TOP_K)
    gate = jax.nn.softmax(top_val, axis=-1).astype(x2d.dtype)
    M = N * TOP_K
    flat_e = top_idx.reshape(M)
    flat_tok = jnp.arange(M, dtype=jnp.int32) // TOP_K
    order = jnp.argsort(flat_e)
    sorted_e = flat_e[order]
    sizes = jnp.bincount(flat_e, length=N_EXPERTS)
    starts = jnp.cumsum(sizes) - sizes
    padded = (sizes + MOE_BLOCK - 1) // MOE_BLOCK * MOE_BLOCK
    pends = jnp.cumsum(padded)
    pstarts = pends - padded
    dest = pstarts[sorted_e] + (jnp.arange(M) - starts[sorted_e])
    n_blocks = -(-M // MOE_BLOCK) + N_EXPERTS
    buf = jnp.zeros((n_blocks * MOE_BLOCK, D), x2d.dtype).at[dest].set(x2d[flat_tok[order]])
    block_e = jnp.clip(jnp.searchsorted(pends, jnp.arange(n_blocks) * MOE_BLOCK, side='right'),
                       0, N_EXPERTS - 1)

    def expert_block(args):
        xb, e = args
        h = xb @ w1[e] + b1[e]
        return clamped_swiglu(h) @ w2[e] + b2[e]

    out_buf = lax.map(expert_block, (buf.reshape(n_blocks, MOE_BLOCK, D), block_e))
    y_sorted = out_buf.reshape(n_blocks * MOE_BLOCK, D)[dest]
    y_assign = jnp.zeros((M, D), x2d.dtype).at[order].set(y_sorted)
    return jnp.einsum('nkd,nk->nd', y_assign.reshape(N, TOP_K, D), gate)


def setup_inputs(seed: int = 0) -> dict:
    keys = iter(jax.random.split(jax.random.key(seed), 48))

    def nrm(shape, scale):
        return scale * jax.random.normal(next(keys), shape, F32)

    Ld = DEPTH
    n_idx = jnp.arange(S5_STATE, dtype=F32)
    return {
        'x': nrm((BATCH, SEQ, D_MODEL), 1.0),
        'mem': nrm((BATCH, N_MEM, D_MODEL), 1.0),
        'w_in': nrm((Ld, D_MODEL, IN_WIDTH), D_MODEL ** -0.5),
        'b_in': nrm((Ld, IN_WIDTH), 0.02),
        'attn_sinks': nrm((Ld, N_Q_HEADS), 0.5),
        's5_lambda_re': -0.5 + nrm((Ld, S5_GROUPS, S5_STATE), 0.01),
        's5_lambda_im': math.pi * n_idx + nrm((Ld, S5_GROUPS, S5_STATE), 0.01),
        's5_log_dt': jax.random.uniform(next(keys), (Ld, S5_GROUPS), F32,
                                        math.log(0.001), math.log(0.1)),
        's5_b_re': nrm((Ld, S5_GROUPS, S5_STATE, S5_GROUP_CH), (2.0 * S5_GROUP_CH) ** -0.5),
        's5_b_im': nrm((Ld, S5_GROUPS, S5_STATE, S5_GROUP_CH), (2.0 * S5_GROUP_CH) ** -0.5),
        's5_c_re': nrm((Ld, S5_GROUPS, S5_GROUP_CH, S5_STATE), S5_STATE ** -0.5),
        's5_c_im': nrm((Ld, S5_GROUPS, S5_GROUP_CH, S5_STATE), S5_STATE ** -0.5),
        's5_d': nrm((Ld, S5_WIDTH), 1.0),
        's5_w_glu': nrm((Ld, S5_WIDTH, S5_WIDTH), S5_WIDTH ** -0.5),
        's5_b_glu': nrm((Ld, S5_WIDTH), 0.02),
        'w_out': nrm((Ld, D_MIX, D_MODEL), D_MIX ** -0.5 * DEEPNORM_BETA),
        'b_out': nrm((Ld, D_MODEL), 0.02),
        'ln1_g': 1.0 + nrm((Ld, D_MODEL), 0.02),
        'ln1_b': nrm((Ld, D_MODEL), 0.02),
        'w_xq': nrm((Ld, D_MODEL, D_MODEL), D_MODEL ** -0.5),
        'w_xkv': nrm((Ld, D_MODEL, 2 * D_MODEL), D_MODEL ** -0.5),
        'w_xo': nrm((Ld, D_MODEL, D_MODEL), D_MODEL ** -0.5 * DEEPNORM_BETA),
        'ln2_g': 1.0 + nrm((Ld, D_MODEL), 0.02),
        'ln2_b': nrm((Ld, D_MODEL), 0.02),
        'w_router': nrm((Ld, D_MODEL, N_EXPERTS), D_MODEL ** -0.5),
        'b_router': nrm((Ld, N_EXPERTS), 0.01),
        'w_e1': nrm((Ld, N_EXPERTS, D_MODEL, 2 * D_EXPERT), D_MODEL ** -0.5),
        'b_e1': nrm((Ld, N_EXPERTS, 2 * D_EXPERT), 0.02),
        'w_e2': nrm((Ld, N_EXPERTS, D_EXPERT, D_MODEL), D_EXPERT ** -0.5 * DEEPNORM_BETA),
        'b_e2': nrm((Ld, N_EXPERTS, D_MODEL), 0.02),
        'ln3_g': 1.0 + nrm((Ld, D_MODEL), 0.02),
        'ln3_b': nrm((Ld, D_MODEL), 0.02),
    }


def reference(x, mem, w_in, b_in, attn_sinks, s5_lambda_re, s5_lambda_im, s5_log_dt,
              s5_b_re, s5_b_im, s5_c_re, s5_c_im, s5_d, s5_w_glu, s5_b_glu, w_out, b_out,
              ln1_g, ln1_b, w_xq, w_xkv, w_xo, ln2_g, ln2_b, w_router, b_router,
              w_e1, b_e1, w_e2, b_e2, ln3_g, ln3_b):
    B, L, D = x.shape
    cos, sin = rope_tables(L)
    for l in range(DEPTH):
        h = x @ w_in[l] + b_in[l]
        q, k, v, u = jnp.split(h, [ATTN_WIDTH, ATTN_WIDTH + KV_WIDTH, ATTN_WIDTH + 2 * KV_WIDTH], axis=-1)
        q = apply_rope(q.reshape(B, L, N_Q_HEADS, HEAD_DIM), cos, sin)
        k = apply_rope(k.reshape(B, L, N_KV_HEADS, HEAD_DIM), cos, sin)
        v = v.reshape(B, L, N_KV_HEADS, HEAD_DIM)
        attn = sliding_window_attention(q, k, v, attn_sinks[l])
        ssm = s5_mixer(u, s5_lambda_re[l], s5_lambda_im[l], s5_log_dt[l], s5_b_re[l], s5_b_im[l],
                       s5_c_re[l], s5_c_im[l], s5_d[l], s5_w_glu[l], s5_b_glu[l])
        mix = jnp.concatenate([attn, ssm], axis=-1) @ w_out[l] + b_out[l]
        x = layer_norm(DEEPNORM_ALPHA * x + mix, ln1_g[l], ln1_b[l])
        xa = memory_cross_attention(x, mem, w_xq[l], w_xkv[l], w_xo[l])
        x = layer_norm(DEEPNORM_ALPHA * x + xa, ln2_g[l], ln2_b[l])
        ff = moe_ffn(x.reshape(B * L, D), w_router[l], b_router[l], w_e1[l], b_e1[l],
                     w_e2[l], b_e2[l]).reshape(B, L, D)
        x = layer_norm(DEEPNORM_ALPHA * x + ff, ln3_g[l], ln3_b[l])
    return x
```

```cpp
#include <hip/hip_runtime.h>
#include <cstdio>
#include <cstdint>

#define GAS __attribute__((address_space(1)))
#define LAS __attribute__((address_space(3)))
typedef unsigned short bf16;
typedef unsigned v4u __attribute__((ext_vector_type(4)));
typedef unsigned v2u __attribute__((ext_vector_type(2)));
typedef float f32x4 __attribute__((ext_vector_type(4)));
typedef float f32x2 __attribute__((ext_vector_type(2)));
typedef float f32x16 __attribute__((ext_vector_type(16)));
typedef short bf16x8 __attribute__((ext_vector_type(8)));

constexpr int BATCH = 2, SEQ = 8192, D = 1024, M = BATCH * SEQ;
constexpr int NIN = 1280, NQK = 640, NHQ = 8, NKV = 2, HD = 64, WIN = 128;
constexpr int S5W = 512, S5G = 32, S5H = 16, S5P = 64, S5T = 32  , S5NCH = M / S5T  , S5KC = S5T * S5H  ;
constexpr int S5BTN = 768;
constexpr int NMEM = 256, XH = 4, XHD = 256;
constexpr int NE = 32, TOPK = 4, DE = 1024, NASG = M * TOPK  ;
constexpr int MPAD = NASG + NE * 256, MTILES = MPAD / 256;
constexpr float LN_EPS = 1e-5f;
constexpr float DN_ALPHA = 1.189207115002721f;
constexpr float SWI_LIMIT = 7.0f, SWI_ALPHA = 1.702f;

constexpr size_t MiB = 1u << 20;
constexpr size_t WS_CTL = 0, CTL_ZERO_BYTES = 1 * MiB;
constexpr size_t WS_MISC = 1 * MiB;
constexpr size_t WS_XB = 3 * MiB;
constexpr size_t WS_MEMB = 35 * MiB;
constexpr size_t WS_WIN = 36 * MiB;
constexpr size_t WS_WOUT = 39 * MiB;
constexpr size_t WS_WXQ = 41 * MiB;
constexpr size_t WS_WXKV = 43 * MiB;
constexpr size_t WS_WXO = 47 * MiB;
constexpr size_t WS_WGLU = 49 * MiB;
constexpr size_t WS_WE1 = 50 * MiB;
constexpr size_t WS_WE2 = 178 * MiB;
constexpr size_t WS_S5BT = 242 * MiB;
constexpr size_t WS_CMAT = 266 * MiB;
constexpr size_t WS_HQK = 274 * MiB;
constexpr size_t WS_VT = 294 * MiB;
constexpr size_t WS_UG = 298 * MiB;
constexpr size_t WS_YI = 314 * MiB;
constexpr size_t WS_SLOC = 346 * MiB;
constexpr size_t WS_SIN = 354 * MiB;
constexpr size_t WS_YB = 362 * MiB;
constexpr size_t WS_KMEM = 378 * MiB;
constexpr size_t WS_VMEMT = 379 * MiB;
constexpr size_t WS_X2 = 380 * MiB;
constexpr size_t WS_X2B = 444 * MiB;
constexpr size_t WS_TOPI = 476 * MiB;
constexpr size_t WS_TOPG = 477 * MiB;
constexpr size_t WS_ROWSLOT = 478 * MiB;
constexpr size_t WS_ROWGATE = 479 * MiB;
constexpr size_t WS_XCHG = 480 * MiB;
constexpr size_t WS_ACT = 482 * MiB;
constexpr size_t WS_MIXCAT = WS_ACT;
constexpr size_t WS_X1 = WS_ACT + 32 * MiB;
constexpr size_t WS_X1B = WS_ACT + 96 * MiB;
constexpr size_t WS_XQ = WS_ACT + 128 * MiB;
constexpr size_t WS_XATT = WS_ACT + 160 * MiB;
constexpr size_t WS_HACT = WS_ACT;
constexpr size_t WS_XG = WS_ACT + 192 * MiB;
constexpr size_t WS_YBUF = WS_XG;
constexpr size_t WS_PRE = WS_XG;
constexpr size_t WS_END = WS_XG + 144 * MiB;
constexpr int MS_BINP = 0;
constexpr int MS_APOW = 2048;
constexpr int MS_BBAR = MS_APOW + 32 * 33 * 64 * 2;
constexpr int MS_KTAB = MS_BBAR + 32 * 64 * 16 * 2;
constexpr int MS_END = MS_KTAB + 32 * 32 * 256;
static_assert(MS_END * 4 <= 2 * (int)MiB, "misc");
constexpr int CW_ECOUNT = 64, CW_ECURSOR = 128;
constexpr int CW_TILEE = 256;
constexpr int CW_NTILES = 1024;

__device__ __forceinline__ unsigned f2bf(float f) { unsigned u = __builtin_bit_cast(unsigned, f); return (u + 0x7fffu + ((u >> 16) & 1u)) >> 16; }
__device__ __forceinline__ float bf2f(unsigned h) { return __builtin_bit_cast(float, h << 16); }
__device__ __forceinline__ unsigned pk2(float lo, float hi) { return f2bf(lo) | (f2bf(hi) << 16); }
__device__ __forceinline__ float wave_sum(float v) {
#pragma unroll
    for (int o = 1; o < 64; o <<= 1) v += __shfl_xor(v, o);
    return v;
}
__device__ __forceinline__ float wave_max(float v) {
#pragma unroll
    for (int o = 1; o < 64; o <<= 1) v = fmaxf(v, __shfl_xor(v, o));
    return v;
}
__device__ __forceinline__ void sincos_rev(double rev, float& s, float& c) {
    const double fr = rev - rint(rev); const float f = (float)fr;
    s = __builtin_amdgcn_sinf(f); c = __builtin_amdgcn_cosf(f);
}
__device__ const double ROPE_REV[32] = {
    1.59154943091895346e-01, 1.19349370211248862e-01, 8.94994016088910133e-02, 6.71150830052272551e-02,
    5.03292121044870353e-02, 3.77415847174197711e-02, 2.83021958306233987e-02, 2.12236527647776604e-02,
    1.59154943091895339e-02, 1.19349370211248862e-02, 8.94994016088910237e-03, 6.71150830052272534e-03,
    5.03292121044870370e-03, 3.77415847174197719e-03, 2.83021958306233987e-03, 2.12236527647776622e-03,
    1.59154943091895356e-03, 1.19349370211248849e-03, 8.94994016088910237e-04, 6.71150830052272599e-04,
    5.03292121044870326e-04, 3.77415847174197741e-04, 2.83021958306233954e-04, 2.12236527647776605e-04,
    1.59154943091895351e-04, 1.19349370211248862e-04, 8.94994016088910182e-05, 6.71150830052272545e-05,
    5.03292121044870354e-05, 3.77415847174197768e-05, 2.83021958306233961e-05, 2.12236527647776592e-05};
__device__ __forceinline__ float gelu_tanh(float x) {
    const float u = 0.7978845608028654f * (x + 0.044715f * x * x * x);
    const float e = __expf(-2.0f * fabsf(u)); const float t = (1.0f - e) / (1.0f + e);
    return 0.5f * x * (1.0f + (u < 0.f ? -t : t));
}
__device__ __forceinline__ float sigmoidf_(float x) { return 1.0f / (1.0f + __expf(-x)); }

__host__ __device__ __forceinline__ int inproj_src(int c) { if (c >= NQK) return c; const int hb = c >> 6, r = c & 63, g = r >> 3, t = r & 7; return hb * 64 + 4 * g + (t & 3) + 32 * (t >> 2); }

struct Ptrs {
    const float* in[32]; float* out; unsigned char* ws;
};
#define WSP(T, off) ((T*)(P.ws + (off)))

struct EpiInProj {
    const float* binp; bf16* hqk; bf16* vt; bf16* ug;
    __device__ __forceinline__ void operator()(int row, int col, const float (&v)[8]) const {
        const int b = row >> 13, pos = row & (SEQ - 1);
        float x[8];
#pragma unroll
        for (int t = 0; t < 8; ++t) x[t] = v[t] + binp[col + t];
        if (col < NQK) {
            const int hb = col >> 6, g8 = (col & 63) >> 3;
            float o1[4], o2[4];
#pragma unroll
            for (int j = 0; j < 4; ++j) { float s, c; sincos_rev((double)pos * ROPE_REV[4 * g8 + j], s, c); o1[j] = x[j] * c - x[j + 4] * s; o2[j] = x[j + 4] * c + x[j] * s; }
            bf16* p = hqk + (size_t)row * NQK + hb * 64 + 4 * g8;
            *(v2u*)p = (v2u){pk2(o1[0], o1[1]), pk2(o1[2], o1[3])};
            *(v2u*)(p + 32) = (v2u){pk2(o2[0], o2[1]), pk2(o2[2], o2[3])};
        } else if (col < NQK + 128) {
            const int kvh = (col - NQK) >> 6, d0 = (col - NQK) & 63;
#pragma unroll
            for (int t = 0; t < 8; ++t) vt[((size_t)(b * NKV + kvh) * HD + d0 + t) * SEQ + pos] = (bf16)f2bf(x[t]);
        } else {
            const int ch = col - (NQK + 128), g = ch >> 4, h0 = ch & 15, c = b * (SEQ / S5T) + (pos >> 5), i = pos & 31;
            *(v4u*)(ug + ((size_t)(g * S5NCH + c) * S5T + i) * S5H + h0) = (v4u){pk2(x[0], x[1]), pk2(x[2], x[3]), pk2(x[4], x[5]), pk2(x[6], x[7])};
        }
    }
};
struct EpiStoreBf16 {
    bf16* out; const float* bias; int ld; int pad;
    __device__ __forceinline__ void operator()(int row, int col, const float (&v)[8]) const {
        float x[8];
#pragma unroll
        for (int t = 0; t < 8; ++t) x[t] = v[t] + (bias ? bias[col + t] : 0.f);
        *(v4u*)(out + (size_t)row * ld + col) = (v4u){pk2(x[0], x[1]), pk2(x[2], x[3]), pk2(x[4], x[5]), pk2(x[6], x[7])};
    }
};
struct EpiGlu {
    const bf16* yb; const float* bglu; bf16* mixcat;
    __device__ __forceinline__ void operator()(int row, int col, const float (&v)[8]) const {
        const v4u yv = *(const v4u*)(yb + (size_t)row * S5W + col);
        float o[8];
#pragma unroll
        for (int t = 0; t < 8; ++t) { const unsigned w = yv[t >> 1]; const float y = bf2f((t & 1) ? (w >> 16) : (w & 0xffffu)); o[t] = y * sigmoidf_(v[t] + bglu[col + t]); }
        *(v4u*)(mixcat + (size_t)row * D + S5W + col) = (v4u){pk2(o[0], o[1]), pk2(o[2], o[3]), pk2(o[4], o[5]), pk2(o[6], o[7])};
    }
};
struct EpiS5a {
    float* yi; float* sloc;
    __device__ __forceinline__ void operator()(int row, int col, const float (&v)[8]) const {
        const int g = col / S5BTN, c = col - g * S5BTN;
        if (c < S5KC) { float* p = yi + (size_t)row * S5KC + c; *(f32x4*)p = (f32x4){v[0], v[1], v[2], v[3]}; *(f32x4*)(p + 4) = (f32x4){v[4], v[5], v[6], v[7]}; }
        else if (c < S5KC + 128) { float* p = sloc + (size_t)row * 128 + (c - S5KC); *(f32x4*)p = (f32x4){v[0], v[1], v[2], v[3]}; *(f32x4*)(p + 4) = (f32x4){v[4], v[5], v[6], v[7]}; }
    }
};
struct EpiS5c {
    const float* yi; const bf16* ug; const float* dskip; bf16* yb;
    __device__ __forceinline__ void operator()(int row, int col, const float (&v)[8]) const {
        const int g = row >> 9, c = row & (S5NCH - 1), n = col & (S5KC - 1), i = n >> 4, h0 = n & 15;
        const float* py = yi + (size_t)row * S5KC + n; const f32x4 y0 = *(const f32x4*)py, y1 = *(const f32x4*)(py + 4);
        const v4u uv = *(const v4u*)(ug + (size_t)row * S5KC + n);
        float o[8];
#pragma unroll
        for (int t = 0; t < 8; ++t) { const unsigned w = uv[t >> 1]; const float u = bf2f((t & 1) ? (w >> 16) : (w & 0xffffu));
            const float y = v[t] + (t < 4 ? y0[t & 3] : y1[t & 3]) + dskip[g * S5H + h0 + t] * u; o[t] = gelu_tanh(y); }
        const int token = c * S5T + i;
        *(v4u*)(yb + (size_t)token * S5W + g * S5H + h0) = (v4u){pk2(o[0], o[1]), pk2(o[2], o[3]), pk2(o[4], o[5]), pk2(o[6], o[7])};
    }
};
struct EpiSwiglu {
    const float* b1; bf16* hact;
    __device__ __forceinline__ void operator()(int row, int col, const float (&v)[8]) const {
        const int c = col & 2047; float o[4];
#pragma unroll
        for (int j = 0; j < 4; ++j) { const float g = fminf(v[2 * j] + b1[col + 2 * j], SWI_LIMIT); const float l = fminf(fmaxf(v[2 * j + 1] + b1[col + 2 * j + 1], -SWI_LIMIT), SWI_LIMIT);
            o[j] = g * sigmoidf_(SWI_ALPHA * g) * (l + 1.0f); }
        *(v2u*)(hact + (size_t)row * DE + (c >> 1)) = (v2u){pk2(o[0], o[1]), pk2(o[2], o[3])};
    }
};
struct EpiMoeOut {
    const float* b2; const int* rowslot; const float* rowgate; bf16* ybuf;
    __device__ __forceinline__ void operator()(int row, int col, const float (&v)[8]) const {
        const int slot = rowslot[row]; if (slot < 0) return;
        const float gt = rowgate[row]; const int c = col & 1023; float o[8];
#pragma unroll
        for (int t = 0; t < 8; ++t) o[t] = (v[t] + b2[col + t]) * gt;
        *(v4u*)(ybuf + (size_t)slot * D + c) = (v4u){pk2(o[0], o[1]), pk2(o[2], o[3]), pk2(o[4], o[5]), pk2(o[6], o[7])};
    }
};
struct EpiPreLN {
    const float* bias; const float* base; float* pre;
    __device__ __forceinline__ void operator()(int row, int col, const float (&v)[8]) const {
#pragma unroll
        for (int t = 0; t < 8; ++t) pre[(size_t)row * D + col + t] = v[t] + (bias ? bias[col + t] : 0.f) + DN_ALPHA * base[(size_t)row * D + col + t];
    }
};
namespace nv {
struct MapId { __device__ __forceinline__ int operator()(int n) const { return n; } };
struct MapInProj { __device__ __forceinline__ int operator()(int n) const { return inproj_src(n); } };
template <class MapT>
__device__ __forceinline__ void transpose_item(const float* W, int K, int N, bf16* WT, LAS float* scr, int item, int lane, MapT mp) {
    const int nblk = N / 32, kb = item / nblk, nb = item % nblk, k0 = 64 * kb, n0 = 32 * nb;
    const int sc = mp(n0 + (lane & 31));
#pragma unroll 8
    for (int i = 0; i < 32; ++i) { const int kk = 2 * i + (lane >> 5); scr[kk * 33 + (lane & 31)] = W[(size_t)(k0 + kk) * N + sc]; }
    asm volatile("s_waitcnt lgkmcnt(0)" ::: "memory");
    const int c = lane & 7;
#pragma unroll
    for (int j = 0; j < 4; ++j) { const int n = (lane >> 3) + 8 * j; const LAS float* s = scr + (8 * c) * 33 + n;
        v4u o; o.x = pk2(s[0 * 33], s[1 * 33]); o.y = pk2(s[2 * 33], s[3 * 33]); o.z = pk2(s[4 * 33], s[5 * 33]); o.w = pk2(s[6 * 33], s[7 * 33]);
        *(v4u*)(WT + (size_t)(n0 + n) * K + k0 + 8 * c) = o; }
    asm volatile("s_waitcnt lgkmcnt(0)" ::: "memory");
}
template <class MapT>
__global__ void __launch_bounds__(256) k_transpose(const float* W, bf16* WT, int K, int N, int nmat, int pad_) {
    const MapT mp{};
    __shared__ float scr_all[4 * 64 * 33];
    const int wave = threadIdx.x >> 6, lane = threadIdx.x & 63;
    LAS float* scr = (LAS float*)scr_all + wave * 64 * 33;
    const int per = (K / 64) * (N / 32), total = per * nmat;
    for (int it = blockIdx.x * 4 + wave; it < total; it += gridDim.x * 4) { const int mi = it / per, r = it % per;
        transpose_item(W + (size_t)mi * K * N, K, N, WT + (size_t)mi * K * N, scr, r, lane, mp); }
}
__global__ void __launch_bounds__(256) k_cvt(const float* src, bf16* dst, size_t n4) {
    for (size_t i = blockIdx.x * 256 + threadIdx.x; i < n4; i += (size_t)gridDim.x * 256) { const f32x4 v = ((const f32x4*)src)[i]; ((v2u*)dst)[i] = (v2u){pk2(v.x, v.y), pk2(v.z, v.w)}; }
}
__global__ void __launch_bounds__(256) k_tables(Ptrs P) {
    float* ms = WSP(float, WS_MISC);
    const int tid = blockIdx.x * 256 + threadIdx.x, nth = gridDim.x * 256;
    for (int c = tid; c < NIN; c += nth) ms[MS_BINP + c] = P.in[3][inproj_src(c)];
    for (int idx = tid; idx < S5G * 33 * S5P; idx += nth) {
        const int p = idx % S5P, j = (idx / S5P) % 33, g = idx / (S5P * 33);
        const double lr = fmin((double)P.in[5][g * S5P + p], -1e-4), li = (double)P.in[6][g * S5P + p], dt = exp((double)P.in[7][g]);
        const double mag = exp(lr * dt * j); float s, c; sincos_rev(li * dt * j * 0.15915494309189535, s, c);
        ms[MS_APOW + 2 * idx] = (float)(mag * c); ms[MS_APOW + 2 * idx + 1] = (float)(mag * s);
    }
    for (int idx = tid; idx < S5G * S5P * S5H; idx += nth) {
        const int h = idx % S5H, p = (idx / S5H) % S5P, g = idx / (S5H * S5P);
        const double lr = fmin((double)P.in[5][g * S5P + p], -1e-4), li = (double)P.in[6][g * S5P + p], dt = exp((double)P.in[7][g]);
        const double mag = exp(lr * dt); float s, c; sincos_rev(li * dt * 0.15915494309189535, s, c);
        const double ar = mag * c, ai = mag * s, den = lr * lr + li * li;
        const double zr = ((ar - 1.0) * lr + ai * li) / den, zi = (ai * lr - (ar - 1.0) * li) / den;
        const double br = P.in[8][idx], bi = P.in[9][idx];
        ms[MS_BBAR + 2 * idx] = (float)(zr * br - zi * bi); ms[MS_BBAR + 2 * idx + 1] = (float)(zr * bi + zi * br);
    }
}
__global__ void __launch_bounds__(256) k_ktab(Ptrs P) {
    float* ms = WSP(float, WS_MISC);
    const int idx = blockIdx.x * 256 + threadIdx.x; if (idx >= S5G * 32 * 256) return;
    const int hi = idx & 15, ho = (idx >> 4) & 15, j = (idx >> 8) & 31, g = idx >> 13;
    float acc = 0.f;
    for (int p = 0; p < S5P; ++p) {
        const float cr = P.in[10][(g * S5H + ho) * S5P + p], ci = P.in[11][(g * S5H + ho) * S5P + p];
        const float ar = ms[MS_APOW + 2 * ((g * 33 + j) * S5P + p)], ai = ms[MS_APOW + 2 * ((g * 33 + j) * S5P + p) + 1];
        const float br = ms[MS_BBAR + 2 * ((g * S5P + p) * S5H + hi)], bi = ms[MS_BBAR + 2 * ((g * S5P + p) * S5H + hi) + 1];
        const float tr = ar * br - ai * bi, ti = ar * bi + ai * br;
        acc += cr * tr - ci * ti;
    }
    ms[MS_KTAB + idx] = acc;
}
__global__ void __launch_bounds__(256) k_s5fill(Ptrs P) {
    const float* ms = WSP(float, WS_MISC); bf16* bt = WSP(bf16, WS_S5BT); bf16* cm = WSP(bf16, WS_CMAT);
    const size_t tid = (size_t)blockIdx.x * 256 + threadIdx.x, nth = (size_t)gridDim.x * 256;
    for (size_t idx = tid; idx < (size_t)S5G * S5BTN * S5KC; idx += nth) {
        const int k = idx % S5KC, n = (idx / S5KC) % S5BTN, g = idx / ((size_t)S5KC * S5BTN), m = k >> 4, hi = k & 15;
        float v = 0.f;
        if (n < S5KC) { const int i = n >> 4, ho = n & 15; if (m <= i) v = ms[MS_KTAB + ((g * 32 + (i - m)) * 16 + ho) * 16 + hi]; }
        else if (n < S5KC + 128) { const int q = n - S5KC, p = q & 63, j = 31 - m;
            const float ar = ms[MS_APOW + 2 * ((g * 33 + j) * S5P + p)], ai = ms[MS_APOW + 2 * ((g * 33 + j) * S5P + p) + 1];
            const float br = ms[MS_BBAR + 2 * ((g * S5P + p) * S5H + hi)], bi = ms[MS_BBAR + 2 * ((g * S5P + p) * S5H + hi) + 1];
            v = (q < 64) ? (ar * br - ai * bi) : (ar * bi + ai * br); }
        bt[idx] = (bf16)f2bf(v);
    }
    for (size_t idx = tid; idx < (size_t)S5G * S5KC * 256; idx += nth) {
        const int k = idx & 255, n = (idx >> 8) & 511, g = idx >> 17, i = n >> 4, ho = n & 15;
        float v = 0.f;
        if (k < 128) { const int p = k & 63, j = i + 1;
            const float cr = P.in[10][(g * S5H + ho) * S5P + p], ci = P.in[11][(g * S5H + ho) * S5P + p];
            const float ar = ms[MS_APOW + 2 * ((g * 33 + j) * S5P + p)], ai = ms[MS_APOW + 2 * ((g * 33 + j) * S5P + p) + 1];
            v = (k < 64) ? (cr * ar - ci * ai) : -(cr * ai + ci * ar); }
        cm[idx] = (bf16)f2bf(v);
    }
}
struct GrpNone { int z0, z1; __device__ __forceinline__ int operator()(int) const { return 0; } };
struct GrpDiv { int rows, pad; __device__ __forceinline__ int operator()(int row) const { return row / rows; } };
struct GrpTable { const int* tile_e; __device__ __forceinline__ int operator()(int row) const { return tile_e[row >> 8]; } };
template <class Epi, class GrpT>
__global__ void __launch_bounds__(256) k_gemm(const bf16* A, const bf16* Bt, GrpT grp, Epi epi, int Mr, int N  , int K, int pad_) {
    __shared__ float As[32][33], Bs[128][33];
    const int row0 = blockIdx.y * 32, col0 = blockIdx.x * 128, tid = threadIdx.x, ty = tid >> 4, tx = tid & 15;
    const int g = grp(row0); if (g < 0) return;
    const bf16* Bg = Bt + (size_t)g * N * K;
    float acc[2][8];
#pragma unroll
    for (int r = 0; r < 2; ++r)
#pragma unroll
        for (int c = 0; c < 8; ++c) acc[r][c] = 0.f;
    for (int k0 = 0; k0 < K; k0 += 32) {
        { const int r = tid >> 3, c4 = (tid & 7) * 4; const v2u w = *(const v2u*)(A + (size_t)(row0 + r) * K + k0 + c4);
          As[r][c4] = bf2f(w.x & 0xffffu); As[r][c4 + 1] = bf2f(w.x >> 16); As[r][c4 + 2] = bf2f(w.y & 0xffffu); As[r][c4 + 3] = bf2f(w.y >> 16); }
#pragma unroll
        for (int q = 0; q < 4; ++q) { const int r = (tid >> 3) + 32 * q, c4 = (tid & 7) * 4; const v2u w = *(const v2u*)(Bg + (size_t)(col0 + r) * K + k0 + c4);
          Bs[r][c4] = bf2f(w.x & 0xffffu); Bs[r][c4 + 1] = bf2f(w.x >> 16); Bs[r][c4 + 2] = bf2f(w.y & 0xffffu); Bs[r][c4 + 3] = bf2f(w.y >> 16); }
        __syncthreads();
#pragma unroll 8
        for (int kk = 0; kk < 32; ++kk) { const float a0 = As[2 * ty][kk], a1 = As[2 * ty + 1][kk];
#pragma unroll
            for (int c = 0; c < 8; ++c) { const float b = Bs[8 * tx + c][kk]; acc[0][c] += a0 * b; acc[1][c] += a1 * b; } }
        __syncthreads();
    }
    epi(row0 + 2 * ty, g * N + col0 + 8 * tx, acc[0]); epi(row0 + 2 * ty + 1, g * N + col0 + 8 * tx, acc[1]);
}
__global__ void __launch_bounds__(256) k_swa(Ptrs P) {
    const bf16* hqk = WSP(bf16, WS_HQK); const bf16* vt = WSP(bf16, WS_VT); bf16* mix = WSP(bf16, WS_MIXCAT);
    const int lane = threadIdx.x & 63, task = blockIdx.x * 4 + (threadIdx.x >> 6); if (task >= M * NHQ) return;
    const int hq = task & 7, token = task >> 3, b = token >> 13, pos = token & (SEQ - 1), kvh = hq >> 2;
    const float q = bf2f(hqk[(size_t)token * NQK + hq * 64 + lane]);
    float m = P.in[4][hq], l = 1.f, o = 0.f;
    const int j0 = pos - (WIN - 1) < 0 ? 0 : pos - (WIN - 1);
    for (int j = j0; j <= pos; ++j) {
        const float k = bf2f(hqk[(size_t)(b * SEQ + j) * NQK + 512 + kvh * 64 + lane]);
        const float s = wave_sum(q * k) * 0.125f;
        const float mn = fmaxf(m, s), sc = __expf(m - mn), p = __expf(s - mn);
        const float v = bf2f(vt[((size_t)(b * NKV + kvh) * HD + lane) * SEQ + j]);
        l = l * sc + p; o = o * sc + p * v; m = mn;
    }
    mix[(size_t)token * D + hq * 64 + lane] = (bf16)f2bf(o / l);
}
__global__ void __launch_bounds__(64) k_s5_direct(Ptrs P) {
    const float* ms = WSP(float, WS_MISC); const bf16* ug = WSP(bf16, WS_UG); bf16* yb = WSP(bf16, WS_YB);
    const int lane = threadIdx.x, g = blockIdx.x & 31, b = blockIdx.x >> 5, p = lane;
    const float ar = ms[MS_APOW + 2 * ((g * 33 + 1) * S5P + p)], ai = ms[MS_APOW + 2 * ((g * 33 + 1) * S5P + p) + 1];
    float br[16], bi[16], cr[16], ci[16];
#pragma unroll
    for (int h = 0; h < 16; ++h) { br[h] = ms[MS_BBAR + 2 * ((g * S5P + p) * S5H + h)]; bi[h] = ms[MS_BBAR + 2 * ((g * S5P + p) * S5H + h) + 1];
        cr[h] = P.in[10][(g * S5H + h) * S5P + p]; ci[h] = P.in[11][(g * S5H + h) * S5P + p]; }
    const float dsk = (lane < 16) ? P.in[12][g * S5H + lane] : 0.f;
    float sr = 0.f, si = 0.f;
    for (int pos = 0; pos < SEQ; ++pos) {
        const int c = b * (SEQ / S5T) + (pos >> 5), i = pos & 31;
        const bf16* up = ug + ((size_t)(g * S5NCH + c) * S5T + i) * S5H;
        float u[16];
#pragma unroll
        for (int h = 0; h < 16; ++h) u[h] = bf2f(up[h]);
        float xr = 0.f, xi = 0.f;
#pragma unroll
        for (int h = 0; h < 16; ++h) { xr += br[h] * u[h]; xi += bi[h] * u[h]; }
        const float nr = ar * sr - ai * si + xr, ni = ar * si + ai * sr + xi; sr = nr; si = ni;
        float mine = 0.f, myu = 0.f;
#pragma unroll
        for (int h = 0; h < 16; ++h) { const float t = wave_sum(cr[h] * sr - ci[h] * si); if (lane == h) { mine = t; myu = u[h]; } }
        if (lane < 16) yb[(size_t)(b * SEQ + pos) * S5W + g * S5H + lane] = (bf16)f2bf(gelu_tanh(mine + dsk * myu));
    }
}
__global__ void __launch_bounds__(64) k_s5_carry(Ptrs P) {
    const float* ms = WSP(float, WS_MISC); const float* sloc = WSP(float, WS_SLOC); bf16* sin_ = WSP(bf16, WS_SIN);
    const int p = threadIdx.x, g = blockIdx.x & 31, b = blockIdx.x >> 5;
    const float ar = ms[MS_APOW + 2 * ((g * 33 + 32) * S5P + p)], ai = ms[MS_APOW + 2 * ((g * 33 + 32) * S5P + p) + 1];
    float sr = 0.f, si = 0.f;
    for (int cc = 0; cc < SEQ / S5T; ++cc) {
        const size_t row = (size_t)g * S5NCH + b * (SEQ / S5T) + cc;
        sin_[row * 256 + p] = (bf16)f2bf(sr); sin_[row * 256 + 64 + p] = (bf16)f2bf(si); sin_[row * 256 + 128 + p] = 0; sin_[row * 256 + 192 + p] = 0;
        const float lr = sloc[row * 128 + p], li = sloc[row * 128 + 64 + p];
        const float nr = ar * sr - ai * si + lr, ni = ar * si + ai * sr + li; sr = nr; si = ni;
    }
}
__global__ void __launch_bounds__(256) k_xattn(Ptrs P) {
    const bf16* xq = WSP(bf16, WS_XQ); const bf16* km = WSP(bf16, WS_KMEM); const bf16* vmt = WSP(bf16, WS_VMEMT); bf16* xa = WSP(bf16, WS_XATT);
    const int lane = threadIdx.x & 63, task = blockIdx.x * 4 + (threadIdx.x >> 6); if (task >= M * XH) return;
    const int h = task & 3, token = task >> 2, b = token >> 13;
    float q[4], o[4] = {0.f, 0.f, 0.f, 0.f};
    { const v2u w = *(const v2u*)(xq + (size_t)token * D + h * XHD + lane * 4); q[0] = bf2f(w.x & 0xffffu); q[1] = bf2f(w.x >> 16); q[2] = bf2f(w.y & 0xffffu); q[3] = bf2f(w.y >> 16); }
    float m = -1e30f, l = 0.f;
    for (int j = 0; j < NMEM; ++j) {
        const v2u w = *(const v2u*)(km + (size_t)(b * NMEM + j) * D + h * XHD + lane * 4);
        const float s = wave_sum(q[0] * bf2f(w.x & 0xffffu) + q[1] * bf2f(w.x >> 16) + q[2] * bf2f(w.y & 0xffffu) + q[3] * bf2f(w.y >> 16)) * 0.0625f;
        const float mn = fmaxf(m, s), sc = __expf(m - mn), p = __expf(s - mn);
        l = l * sc + p; m = mn;
#pragma unroll
        for (int t = 0; t < 4; ++t) o[t] = o[t] * sc + p * bf2f(vmt[(size_t)(h * XHD + lane * 4 + t) * (BATCH * NMEM) + b * NMEM + j]);
    }
    const float il = 1.f / l;
    *(v2u*)(xa + (size_t)token * D + h * XHD + lane * 4) = (v2u){pk2(o[0] * il, o[1] * il), pk2(o[2] * il, o[3] * il)};
}
__global__ void __launch_bounds__(256) k_ln(const float* pre, const float* gam, const float* bet, float* xo, bf16* xob) {
    const int lane = threadIdx.x & 63, row = blockIdx.x * 4 + (threadIdx.x >> 6); if (row >= M) return;
    f32x4 v[4]; float s = 0.f;
#pragma unroll
    for (int j = 0; j < 4; ++j) { v[j] = ((const f32x4*)(pre + (size_t)row * D))[lane + 64 * j]; s += (v[j].x + v[j].y) + (v[j].z + v[j].w); }
    const float mean = wave_sum(s) * (1.f / D); float s2 = 0.f;
#pragma unroll
    for (int j = 0; j < 4; ++j) { v[j] = v[j] - mean; s2 += (v[j].x * v[j].x + v[j].y * v[j].y) + (v[j].z * v[j].z + v[j].w * v[j].w); }
    const float rstd = 1.f / sqrtf(wave_sum(s2) * (1.f / D) + LN_EPS);
#pragma unroll
    for (int j = 0; j < 4; ++j) { const f32x4 gg = ((const f32x4*)gam)[lane + 64 * j], bb = ((const f32x4*)bet)[lane + 64 * j]; const f32x4 o = v[j] * rstd * gg + bb;
        ((f32x4*)(xo + (size_t)row * D))[lane + 64 * j] = o; if (xob) ((v2u*)(xob + (size_t)row * D))[lane + 64 * j] = (v2u){pk2(o.x, o.y), pk2(o.z, o.w)}; }
}
__global__ void __launch_bounds__(256) k_router(Ptrs P) {
    const float* x2 = WSP(float, WS_X2); const float* wr = P.in[24]; const float* brt = P.in[25];
    int* topi = WSP(int, WS_TOPI); float* topg = WSP(float, WS_TOPG); unsigned* ctl = WSP(unsigned, WS_CTL);
    const int token = blockIdx.x * 256 + threadIdx.x; if (token >= M) return;
    float acc[32];
#pragma unroll
    for (int e = 0; e < 32; ++e) acc[e] = brt[e];
    for (int k = 0; k < D; k += 4) { const f32x4 xv = *(const f32x4*)(x2 + (size_t)token * D + k);
#pragma unroll
        for (int kk = 0; kk < 4; ++kk) {
#pragma unroll
            for (int e = 0; e < 32; ++e) acc[e] += xv[kk] * wr[(k + kk) * NE + e]; } }
    unsigned taken = 0u; float tv[4]; int ti[4];
#pragma unroll
    for (int r = 0; r < 4; ++r) { float best = -3.0e38f; int bi = 0;
#pragma unroll
        for (int e = 0; e < 32; ++e) { const bool ok = !((taken >> e) & 1u) && acc[e] > best; best = ok ? acc[e] : best; bi = ok ? e : bi; }
        taken |= 1u << bi; tv[r] = best; ti[r] = bi; }
    const float e1 = __expf(tv[1] - tv[0]), e2 = __expf(tv[2] - tv[0]), e3 = __expf(tv[3] - tv[0]), inv = 1.f / (1.f + e1 + e2 + e3);
    const float gt[4] = {inv, e1 * inv, e2 * inv, e3 * inv};
#pragma unroll
    for (int r = 0; r < 4; ++r) { topi[token * 4 + r] = ti[r]; topg[token * 4 + r] = gt[r]; atomicAdd(&ctl[CW_ECOUNT + ti[r]], 1u); }
}
__global__ void __launch_bounds__(256) k_moe_init(Ptrs P) {
    int* rowslot = WSP(int, WS_ROWSLOT); unsigned* ctl = WSP(unsigned, WS_CTL);
    for (int i = blockIdx.x * 256 + threadIdx.x; i < MPAD; i += gridDim.x * 256) rowslot[i] = -1;
    if (blockIdx.x == 0 && threadIdx.x == 0) { int t = 0;
        for (int e = 0; e < NE; ++e) { const int nt = ((int)ctl[CW_ECOUNT + e] + 255) >> 8; for (int q = 0; q < nt; ++q) ctl[CW_TILEE + t++] = (unsigned)e; }
        ctl[CW_NTILES] = (unsigned)t; for (; t < MTILES; ++t) ctl[CW_TILEE + t] = 0xffffffffu; }
}
__global__ void __launch_bounds__(256) k_scatter(Ptrs P) {
    const int* topi = WSP(int, WS_TOPI); const float* topg = WSP(float, WS_TOPG); unsigned* ctl = WSP(unsigned, WS_CTL);
    int* rowslot = WSP(int, WS_ROWSLOT); float* rowgate = WSP(float, WS_ROWGATE); const bf16* x2b = WSP(bf16, WS_X2B); bf16* xg = WSP(bf16, WS_XG);
    const int lane = threadIdx.x & 63, a = blockIdx.x * 4 + (threadIdx.x >> 6); if (a >= NASG) return;
    const int e = topi[a]; int pos = 0;
    if (lane == 0) { int off = 0; for (int q = 0; q < e; ++q) off += (((int)ctl[CW_ECOUNT + q] + 255) >> 8) << 8; pos = off + (int)atomicAdd(&ctl[CW_ECURSOR + e], 1u); rowslot[pos] = a; rowgate[pos] = topg[a]; }
    pos = __shfl(pos, 0);
    const v4u* src = (const v4u*)(x2b + (size_t)(a >> 2) * D); v4u* dst = (v4u*)(xg + (size_t)pos * D);
    dst[lane] = src[lane]; dst[lane + 64] = src[lane + 64];
}
__global__ void __launch_bounds__(256) k_final(Ptrs P) {
    const float* x2 = WSP(float, WS_X2); const bf16* yb = WSP(bf16, WS_YBUF); const float* gam = P.in[30]; const float* bet = P.in[31];
    const int lane = threadIdx.x & 63, row = blockIdx.x * 4 + (threadIdx.x >> 6); if (row >= M) return;
    f32x4 v[4]; float s = 0.f;
#pragma unroll
    for (int j = 0; j < 4; ++j) { v[j] = ((const f32x4*)(x2 + (size_t)row * D))[lane + 64 * j] * DN_ALPHA;
#pragma unroll
        for (int k = 0; k < 4; ++k) { const v2u w = ((const v2u*)(yb + (size_t)(row * 4 + k) * D))[lane + 64 * j];
            v[j].x += bf2f(w.x & 0xffffu); v[j].y += bf2f(w.x >> 16); v[j].z += bf2f(w.y & 0xffffu); v[j].w += bf2f(w.y >> 16); }
        s += (v[j].x + v[j].y) + (v[j].z + v[j].w); }
    const float mean = wave_sum(s) * (1.f / D); float s2 = 0.f;
#pragma unroll
    for (int j = 0; j < 4; ++j) { v[j] = v[j] - mean; s2 += (v[j].x * v[j].x + v[j].y * v[j].y) + (v[j].z * v[j].z + v[j].w * v[j].w); }
    const float rstd = 1.f / sqrtf(wave_sum(s2) * (1.f / D) + LN_EPS);
#pragma unroll
    for (int j = 0; j < 4; ++j) { const f32x4 gg = ((const f32x4*)gam)[lane + 64 * j], bb = ((const f32x4*)bet)[lane + 64 * j];
        ((f32x4*)(P.out + (size_t)row * D))[lane + 64 * j] = v[j] * rstd * gg + bb; }
}
}
#ifndef S5_CHUNKED
#define S5_CHUNKED 1
#endif
extern "C" void kernel_launch(void* const* d_in, const int* in_sizes, int n_in, void* d_out, int out_size, void* d_ws, size_t ws_size, hipStream_t stream) {
    if (n_in != 32 || out_size != M * D || ws_size < WS_END) { fprintf(stderr, "kernel_launch: unexpected shapes n_in %d out %d ws %zu (need %zu)\n", n_in, out_size, ws_size, (size_t)WS_END); return; }
    Ptrs P{}; for (int i = 0; i < 32; ++i) P.in[i] = (const float*)d_in[i]; P.out = (float*)d_out; P.ws = (unsigned char*)d_ws;
    (void)hipMemsetAsync((char*)d_ws + WS_CTL, 0, CTL_ZERO_BYTES, stream);
    using namespace nv;
    k_cvt<<<2048, 256, 0, stream>>>(P.in[0], WSP(bf16, WS_XB), (size_t)M * D / 4);
    k_cvt<<<256, 256, 0, stream>>>(P.in[1], WSP(bf16, WS_MEMB), (size_t)BATCH * NMEM * D / 4);
    k_transpose<MapInProj><<<512, 256, 0, stream>>>(P.in[2], WSP(bf16, WS_WIN), D, NIN, 1, 0);
    k_transpose<MapId><<<512, 256, 0, stream>>>(P.in[15], WSP(bf16, WS_WOUT), D, D, 1, 0);
    k_transpose<MapId><<<512, 256, 0, stream>>>(P.in[19], WSP(bf16, WS_WXQ), D, D, 1, 0);
    k_transpose<MapId><<<512, 256, 0, stream>>>(P.in[20], WSP(bf16, WS_WXKV), D, 2 * D, 1, 0);
    k_transpose<MapId><<<512, 256, 0, stream>>>(P.in[21], WSP(bf16, WS_WXO), D, D, 1, 0);
    k_transpose<MapId><<<256, 256, 0, stream>>>(P.in[13], WSP(bf16, WS_WGLU), S5W, S5W, 1, 0);
    k_transpose<MapId><<<2048, 256, 0, stream>>>(P.in[26], WSP(bf16, WS_WE1), D, 2 * DE, NE, 0);
    k_transpose<MapId><<<2048, 256, 0, stream>>>(P.in[28], WSP(bf16, WS_WE2), DE, D, NE, 0);
    k_tables<<<256, 256, 0, stream>>>(P);
    k_ktab<<<S5G * 32, 256, 0, stream>>>(P);
    k_s5fill<<<2048, 256, 0, stream>>>(P);
    k_gemm<<<dim3(NIN / 128, M / 32), 256, 0, stream>>>(WSP(bf16, WS_XB), WSP(bf16, WS_WIN), GrpNone{0, 0}, EpiInProj{WSP(float, WS_MISC) + MS_BINP, WSP(bf16, WS_HQK), WSP(bf16, WS_VT), WSP(bf16, WS_UG)}, M, NIN, D, 0);
    k_gemm<<<dim3(D / 128, 512 / 32), 256, 0, stream>>>(WSP(bf16, WS_MEMB), WSP(bf16, WS_WXKV), GrpNone{0, 0}, EpiStoreBf16{WSP(bf16, WS_KMEM), nullptr, D, 0}, 512, D, D, 0);
    k_gemm<<<dim3(512 / 128, D / 32), 256, 0, stream>>>(WSP(bf16, WS_WXKV) + (size_t)D * D, WSP(bf16, WS_MEMB), GrpNone{0, 0}, EpiStoreBf16{WSP(bf16, WS_VMEMT), nullptr, 512, 0}, D, 512, D, 0);
    k_swa<<<M * NHQ / 4, 256, 0, stream>>>(P);
#if S5_CHUNKED
    k_gemm<<<dim3(S5BTN / 128, M / 32), 256, 0, stream>>>(WSP(bf16, WS_UG), WSP(bf16, WS_S5BT), GrpDiv{S5NCH, 0}, EpiS5a{WSP(float, WS_YI), WSP(float, WS_SLOC)}, M, S5BTN, S5KC, 0);
    k_s5_carry<<<BATCH * S5G, 64, 0, stream>>>(P);
    k_gemm<<<dim3(S5KC / 128, M / 32), 256, 0, stream>>>(WSP(bf16, WS_SIN), WSP(bf16, WS_CMAT), GrpDiv{S5NCH, 0}, EpiS5c{WSP(float, WS_YI), WSP(bf16, WS_UG), P.in[12], WSP(bf16, WS_YB)}, M, S5KC, 256, 0);
#else
    k_s5_direct<<<BATCH * S5G, 64, 0, stream>>>(P);
#endif
    k_gemm<<<dim3(S5W / 128, M / 32), 256, 0, stream>>>(WSP(bf16, WS_YB), WSP(bf16, WS_WGLU), GrpNone{0, 0}, EpiGlu{WSP(bf16, WS_YB), P.in[14], WSP(bf16, WS_MIXCAT)}, M, S5W, S5W, 0);
    k_gemm<<<dim3(D / 128, M / 32), 256, 0, stream>>>(WSP(bf16, WS_MIXCAT), WSP(bf16, WS_WOUT), GrpNone{0, 0}, EpiPreLN{P.in[16], P.in[0], WSP(float, WS_PRE)}, M, D, D, 0);
    k_ln<<<M / 4, 256, 0, stream>>>(WSP(float, WS_PRE), P.in[17], P.in[18], WSP(float, WS_X1), WSP(bf16, WS_X1B));
    k_gemm<<<dim3(D / 128, M / 32), 256, 0, stream>>>(WSP(bf16, WS_X1B), WSP(bf16, WS_WXQ), GrpNone{0, 0}, EpiStoreBf16{WSP(bf16, WS_XQ), nullptr, D, 0}, M, D, D, 0);
    k_xattn<<<M * XH / 4, 256, 0, stream>>>(P);
    k_gemm<<<dim3(D / 128, M / 32), 256, 0, stream>>>(WSP(bf16, WS_XATT), WSP(bf16, WS_WXO), GrpNone{0, 0}, EpiPreLN{nullptr, WSP(float, WS_X1), WSP(float, WS_PRE)}, M, D, D, 0);
    k_ln<<<M / 4, 256, 0, stream>>>(WSP(float, WS_PRE), P.in[22], P.in[23], WSP(float, WS_X2), WSP(bf16, WS_X2B));
    k_router<<<M / 256, 256, 0, stream>>>(P);
    k_moe_init<<<64, 256, 0, stream>>>(P);
    k_scatter<<<NASG / 4, 256, 0, stream>>>(P);
    k_gemm<<<dim3(2 * DE / 128, MPAD / 32), 256, 0, stream>>>(WSP(bf16, WS_XG), WSP(bf16, WS_WE1), GrpTable{(const int*)(WSP(unsigned, WS_CTL) + CW_TILEE)}, EpiSwiglu{P.in[27], WSP(bf16, WS_HACT)}, MPAD, 2 * DE, D, 0);
    k_gemm<<<dim3(D / 128, MPAD / 32), 256, 0, stream>>>(WSP(bf16, WS_HACT), WSP(bf16, WS_WE2), GrpTable{(const int*)(WSP(unsigned, WS_CTL) + CW_TILEE)}, EpiMoeOut{P.in[29], WSP(int, WS_ROWSLOT), WSP(float, WS_ROWGATE), WSP(bf16, WS_YBUF)}, MPAD, D, DE, 0);
    k_final<<<M / 4, 256, 0, stream>>>(P);
}
```
